# Optimizing an MI355X kernel written in HIP

```python
import math
import jax, jax.numpy as jnp
from jax import lax
import numpy as np

D_MODEL = 1024
BATCH = 4
SEQ = 4096
DEPTH = 4

CHUNK = 64
N_META = 16
Q_BLOCK = 128
N_MIXERS = 2
MLA_HEADS = 16
QK_NOPE = 64
QK_ROPE = 32
V_HEAD = 64
Q_LORA = 384
KV_LORA = 256
MLA_WIDTH = MLA_HEADS * V_HEAD
MLA_IN = Q_LORA + KV_LORA + QK_ROPE + MLA_WIDTH
ROPE_BASE = 10000.0
CONV_WIDTH = D_MODEL
CONV_K = 3
CONV_IN = 4 * CONV_WIDTH
DN_ALPHA = (2 * DEPTH) ** 0.25
DN_BETA = (8 * DEPTH) ** -0.25
N_MLA_LAYERS = (DEPTH + 1) // 2
N_CONV_LAYERS = DEPTH // 2
LN_EPS = 1e-5
RMS_EPS = 1e-6
NEG_INF = -1e30

kernel_name = 'chunked_mla_shortconv_deepnorm_trunk'


def layer_norm(x, g, b):
    xf = x.astype(jnp.float32)
    mu = jnp.mean(xf, axis=-1, keepdims=True)
    var = jnp.mean(jnp.square(xf - mu), axis=-1, keepdims=True)
    y = (xf - mu) * lax.rsqrt(var + LN_EPS) * g.astype(jnp.float32) + b.astype(jnp.float32)
    return y.astype(x.dtype)


def rms_norm(x, g):
    xf = x.astype(jnp.float32)
    y = xf * lax.rsqrt(jnp.mean(jnp.square(xf), axis=-1, keepdims=True) + RMS_EPS)
    return (y * g.astype(jnp.float32)).astype(x.dtype)


def rope(x, cos, sin):
    x1, x2 = jnp.split(x, 2, axis=-1)
    return jnp.concatenate([x1 * cos - x2 * sin, x1 * sin + x2 * cos], axis=-1)


def mla_mixer(h, w_in, q_norm_g, w_uq, kv_norm_g, w_uk, w_uv, w_o, cos, sin):
    bsz, L, _ = h.shape
    proj = h @ w_in
    c_q, c_kv, k_rope, z = jnp.split(
        proj, [Q_LORA, Q_LORA + KV_LORA, Q_LORA + KV_LORA + QK_ROPE], axis=-1)
    q = (rms_norm(c_q, q_norm_g) @ w_uq).reshape(bsz, L, MLA_HEADS, QK_NOPE + QK_ROPE)
    q_nope = q[..., :QK_NOPE]
    q_rope = rope(q[..., QK_NOPE:], cos[:, :, None, :], sin[:, :, None, :])
    c_kv = rms_norm(c_kv, kv_norm_g)
    k_nope = (c_kv @ w_uk).reshape(bsz, L, MLA_HEADS, QK_NOPE)
    v = (c_kv @ w_uv).reshape(bsz, L, MLA_HEADS, V_HEAD)
    k_rope = rope(k_rope, cos, sin)
    frame_chunk = 1 + jnp.arange(SEQ, dtype=jnp.int32) // CHUNK
    key_chunk = jnp.concatenate([jnp.zeros((N_META,), jnp.int32), frame_chunk])
    scale = (QK_NOPE + QK_ROPE) ** -0.5

    def attend(qn, qr, q_chunk):
        s = (jnp.einsum('bqhd,bkhd->bhqk', qn, k_nope)
             + jnp.einsum('bqhr,bkr->bhqk', qr, k_rope)).astype(jnp.float32) * scale
        mask = key_chunk[None, :] <= q_chunk[:, None]
        s = jnp.where(mask[None, None], s, NEG_INF)
        p = jax.nn.softmax(s, axis=-1).astype(v.dtype)
        return jnp.einsum('bhqk,bkhd->bqhd', p, v)

    o_meta = attend(q_nope[:, :N_META], q_rope[:, :N_META],
                    jnp.zeros((N_META,), jnp.int32))
    n_blk = SEQ // Q_BLOCK
    qn_f = q_nope[:, N_META:].reshape(bsz, n_blk, Q_BLOCK, MLA_HEADS, QK_NOPE).transpose(1, 0, 2, 3, 4)
    qr_f = q_rope[:, N_META:].reshape(bsz, n_blk, Q_BLOCK, MLA_HEADS, QK_ROPE).transpose(1, 0, 2, 3, 4)
    qc_f = frame_chunk.reshape(n_blk, Q_BLOCK)
    o_f = lax.map(lambda a: attend(a[0], a[1], a[2]), (qn_f, qr_f, qc_f))
    o_f = o_f.transpose(1, 0, 2, 3, 4).reshape(bsz, SEQ, MLA_HEADS, V_HEAD)
    o = jnp.concatenate([o_meta, o_f], axis=1).reshape(bsz, L, MLA_WIDTH)
    return (o * jax.nn.silu(z)) @ w_o


def conv_mixer(h, w_in, conv_w, w_out):
    L = h.shape[1]
    b_gate, c_gate, u, z = jnp.split(h @ w_in, 4, axis=-1)
    cu = jnp.pad(c_gate * u, ((0, 0), (CONV_K - 1, 0), (0, 0)))
    conv = cu[:, 0:L] * conv_w[0]
    for k in range(1, CONV_K):
        conv = conv + cu[:, k:k + L] * conv_w[k]
    return (b_gate * conv * jax.nn.silu(z)) @ w_out


def setup_inputs(seed: int = 0) -> dict:
    key = jax.random.key(seed)
    ks = jax.random.split(key, 20)
    f32 = jnp.float32
    nrm = lambda k, shape, s: jax.random.normal(k, shape, f32) * s
    x = nrm(ks[0], (BATCH, SEQ, D_MODEL), 1.0)
    offset = jax.random.randint(ks[1], (BATCH, 1), 0, 8, dtype=jnp.int32) * CHUNK
    positions = (offset + jnp.arange(SEQ, dtype=jnp.int32)[None, :]).astype(jnp.int32)
    meta_tokens = nrm(ks[2], (N_META, D_MODEL), 1.0)
    ln_g = 1.0 + nrm(ks[3], (DEPTH, D_MODEL), 0.02)
    ln_b = nrm(ks[4], (DEPTH, D_MODEL), 0.02)
    mla_w_in = nrm(ks[5], (N_MLA_LAYERS, D_MODEL, MLA_IN), D_MODEL ** -0.5)
    mla_q_norm_g = 1.0 + nrm(ks[6], (N_MLA_LAYERS, Q_LORA), 0.02)
    mla_w_uq = nrm(ks[7], (N_MLA_LAYERS, Q_LORA, MLA_HEADS * (QK_NOPE + QK_ROPE)), Q_LORA ** -0.5)
    mla_kv_norm_g = 1.0 + nrm(ks[8], (N_MLA_LAYERS, KV_LORA), 0.02)
    mla_w_uk = nrm(ks[9], (N_MLA_LAYERS, KV_LORA, MLA_HEADS * QK_NOPE), KV_LORA ** -0.5)
    mla_w_uv = nrm(ks[10], (N_MLA_LAYERS, KV_LORA, MLA_HEADS * V_HEAD), KV_LORA ** -0.5 * DN_BETA)
    mla_w_o = nrm(ks[11], (N_MLA_LAYERS, MLA_WIDTH, D_MODEL), MLA_WIDTH ** -0.5 * DN_BETA)
    conv_w_in = nrm(ks[12], (N_CONV_LAYERS, D_MODEL, CONV_IN), D_MODEL ** -0.5)
    conv_w = nrm(ks[13], (N_CONV_LAYERS, CONV_K, CONV_WIDTH), CONV_K ** -0.5)
    conv_w_out = nrm(ks[14], (N_CONV_LAYERS, CONV_WIDTH, D_MODEL), CONV_WIDTH ** -0.5 * DN_BETA)
    return {'x': x, 'positions': positions, 'meta_tokens': meta_tokens,
            'ln_g': ln_g, 'ln_b': ln_b,
            'mla_w_in': mla_w_in, 'mla_q_norm_g': mla_q_norm_g, 'mla_w_uq': mla_w_uq,
            'mla_kv_norm_g': mla_kv_norm_g, 'mla_w_uk': mla_w_uk, 'mla_w_uv': mla_w_uv,
            'mla_w_o': mla_w_o,
            'conv_w_in': conv_w_in, 'conv_w': conv_w, 'conv_w_out': conv_w_out}


def reference(x, positions, meta_tokens, ln_g, ln_b,
              mla_w_in, mla_q_norm_g, mla_w_uq, mla_kv_norm_g, mla_w_uk, mla_w_uv, mla_w_o,
              conv_w_in, conv_w, conv_w_out):
    bsz = x.shape[0]
    meta = jnp.broadcast_to(meta_tokens[None].astype(x.dtype), (bsz, N_META, D_MODEL))
    h = jnp.concatenate([meta, x], axis=1)
    meta_pos = jnp.broadcast_to(jnp.arange(N_META, dtype=jnp.int32)[None], (bsz, N_META))
    rope_pos = jnp.concatenate([meta_pos, positions + N_META], axis=1).astype(jnp.float32)
    inv_freq = ROPE_BASE ** (-jnp.arange(0, QK_ROPE, 2, dtype=jnp.float32) / QK_ROPE)
    ang = rope_pos[..., None] * inv_freq
    cos = jnp.cos(ang).astype(x.dtype)
    sin = jnp.sin(ang).astype(x.dtype)
    for i in range(DEPTH):
        j = i // N_MIXERS
        if i % N_MIXERS == 0:
            out = mla_mixer(h, mla_w_in[j], mla_q_norm_g[j], mla_w_uq[j], mla_kv_norm_g[j],
                            mla_w_uk[j], mla_w_uv[j], mla_w_o[j], cos, sin)
        else:
            out = conv_mixer(h, conv_w_in[j], conv_w[j], conv_w_out[j])
        h = layer_norm(DN_ALPHA * h + out, ln_g[i], ln_b[i])
    return h[:, N_META:]
```

```cpp
#include <hip/hip_runtime.h>
#include <cstdint>
#include <cstddef>

namespace v0 {
constexpr int D = 1024, BATCH = 4, SEQ = 4096, NMETA = 16, L = SEQ + NMETA;
constexpr int HEADS = 16, QKN = 64, QKR = 32, VH = 64, QL = 384, KVL = 256;
constexpr int MLA_IN = QL + KVL + QKR + HEADS * VH;
constexpr int QW = HEADS * (QKN + QKR);
constexpr int CONV_IN = 4096;
constexpr float LN_EPS = 1e-5f, RMS_EPS = 1e-6f;

__global__ void build_h(const float* __restrict__ x, const float* __restrict__ meta, float* __restrict__ H) {
    const size_t n = (size_t)BATCH * L * D;
    for (size_t i = (size_t)blockIdx.x * blockDim.x + threadIdx.x; i < n; i += (size_t)gridDim.x * blockDim.x) {
        const int d = (int)(i % D); const size_t r = i / D; const int l = (int)(r % L); const int b = (int)(r / L);
        H[i] = (l < NMETA) ? meta[l * D + d] : x[((size_t)b * SEQ + (l - NMETA)) * D + d];
    }
}
__global__ void rope_table(const int* __restrict__ pos, float* __restrict__ cs, float* __restrict__ sn) {
    const int n = BATCH * L * 16;
    for (int i = blockIdx.x * blockDim.x + threadIdx.x; i < n; i += gridDim.x * blockDim.x) {
        const int j = i % 16; const int r = i / 16; const int l = r % L; const int b = r / L;
        const float p = (l < NMETA) ? (float)l : (float)(pos[b * SEQ + (l - NMETA)] + NMETA);
        const float inv = (float)pow(10000.0, -(double)(2 * j) / 32.0);
        const float ang = p * inv;
        cs[i] = (float)cos((double)ang); sn[i] = (float)sin((double)ang);
    }
}
__global__ void __launch_bounds__(256) gemm_f32(const float* __restrict__ A, int lda, const float* __restrict__ W, int ldw,
                                                float* __restrict__ C, int ldc, int M, int N, int K) {
    __shared__ float As[16][68];
    __shared__ float Ws[16][68];
    const int tx = threadIdx.x & 15, ty = threadIdx.x >> 4;
    const int m0 = blockIdx.y * 64, n0 = blockIdx.x * 64;
    float acc[4][4];
#pragma unroll
    for (int i = 0; i < 4; ++i)
#pragma unroll
        for (int j = 0; j < 4; ++j) acc[i][j] = 0.f;
    for (int k0 = 0; k0 < K; k0 += 16) {
#pragma unroll
        for (int i = 0; i < 4; ++i) {
            const int idx = threadIdx.x + i * 256;
            { const int r = idx >> 4, kk = idx & 15; As[kk][r] = (m0 + r < M) ? A[(size_t)(m0 + r) * lda + k0 + kk] : 0.f; }
            { const int kk = idx >> 6, c = idx & 63; Ws[kk][c] = (n0 + c < N) ? W[(size_t)(k0 + kk) * ldw + n0 + c] : 0.f; }
        }
        __syncthreads();
#pragma unroll
        for (int kk = 0; kk < 16; ++kk) {
            float a[4], w[4];
#pragma unroll
            for (int i = 0; i < 4; ++i) { a[i] = As[kk][ty * 4 + i]; w[i] = Ws[kk][tx * 4 + i]; }
#pragma unroll
            for (int i = 0; i < 4; ++i)
#pragma unroll
                for (int j = 0; j < 4; ++j) acc[i][j] = fmaf(a[i], w[j], acc[i][j]);
        }
        __syncthreads();
    }
#pragma unroll
    for (int i = 0; i < 4; ++i) {
        const int r = m0 + ty * 4 + i; if (r >= M) continue;
#pragma unroll
        for (int j = 0; j < 4; ++j) { const int c = n0 + tx * 4 + j; if (c < N) C[(size_t)r * ldc + c] = acc[i][j]; }
    }
}
__device__ __forceinline__ float wave_sum(float v) {
#pragma unroll
    for (int o = 1; o < 64; o <<= 1) v += __shfl_xor(v, o);
    return v;
}
__global__ void rmsnorm_inplace(float* __restrict__ P, int ld, int col0, int ncols, const float* __restrict__ g, int rows) {
    const int lane = threadIdx.x & 63; const int row = blockIdx.x * (blockDim.x >> 6) + (threadIdx.x >> 6);
    if (row >= rows) return;
    float* p = P + (size_t)row * ld + col0; float s = 0.f;
    for (int c = lane; c < ncols; c += 64) s += p[c] * p[c];
    s = wave_sum(s);
    const float r = 1.0f / sqrtf(s / (float)ncols + RMS_EPS);
    for (int c = lane; c < ncols; c += 64) p[c] = p[c] * r * g[c];
}
__global__ void rope_inplace(float* __restrict__ P, int ld, int col0, int nh, int stride, const float* __restrict__ cs, const float* __restrict__ sn, int rows) {
    const int n = rows * nh * 16;
    for (int i = blockIdx.x * blockDim.x + threadIdx.x; i < n; i += gridDim.x * blockDim.x) {
        const int j = i % 16; const int h = (i / 16) % nh; const int row = i / (16 * nh);
        float* p = P + (size_t)row * ld + col0 + h * stride;
        const float c = cs[row * 16 + j], s = sn[row * 16 + j];
        const float x1 = p[j], x2 = p[16 + j];
        p[j] = x1 * c - x2 * s; p[16 + j] = x1 * s + x2 * c;
    }
}
__global__ void __launch_bounds__(64) attn_naive(const float* __restrict__ Q, const float* __restrict__ KN, const float* __restrict__ P  ,
                                                 const float* __restrict__ V, float* __restrict__ G) {
    __shared__ float Ks[16][96];
    __shared__ float Vs[16][64];
    const int c = blockIdx.x, h = blockIdx.y, tid = threadIdx.x;
    const int nq = (c == 0) ? NMETA : 64;
    const int l = (c == 0) ? tid : NMETA + 64 * (c - 1) + tid;
    const int nkeys = NMETA + 64 * c;
    const bool act = tid < nq;
    float q[96], o[64];
#pragma unroll
    for (int d = 0; d < 96; ++d) q[d] = act ? Q[(size_t)l * QW + h * 96 + d] : 0.f;
#pragma unroll
    for (int d = 0; d < 64; ++d) o[d] = 0.f;
    float m = -1e30f, lsum = 0.f;
    const float scale = 1.0f / sqrtf(96.0f);
    for (int k0 = 0; k0 < nkeys; k0 += 16) {
        __syncthreads();
        for (int i = tid; i < 16 * 96; i += 64) { const int kk = i / 96, d = i % 96; const int kl = k0 + kk;
            Ks[kk][d] = (d < 64) ? KN[(size_t)kl * D + h * 64 + d] : P[(size_t)kl * CONV_IN + 640 + (d - 64)]; }
        for (int i = tid; i < 16 * 64; i += 64) { const int kk = i / 64, d = i % 64; Vs[kk][d] = V[(size_t)(k0 + kk) * D + h * 64 + d]; }
        __syncthreads();
        for (int kk = 0; kk < 16; ++kk) {
            float s = 0.f;
#pragma unroll
            for (int d = 0; d < 96; ++d) s = fmaf(q[d], Ks[kk][d], s);
            s *= scale;
            const float mn = fmaxf(m, s);
            const float f = __expf(m - mn), p = __expf(s - mn);
            lsum = lsum * f + p; m = mn;
#pragma unroll
            for (int d = 0; d < 64; ++d) o[d] = fmaf(p, Vs[kk][d], o[d] * f);
        }
    }
    if (act) {
        const float inv = 1.0f / lsum;
#pragma unroll
        for (int d = 0; d < 64; ++d) { const float z = P[(size_t)l * CONV_IN + 672 + h * 64 + d]; G[(size_t)l * D + h * 64 + d] = o[d] * inv * (z / (1.0f + __expf(-z))); }
    }
}
__global__ void __launch_bounds__(256) ln_residual(float* __restrict__ H, const float* __restrict__ O, const float* __restrict__ g, const float* __restrict__ b, float alpha) {
    __shared__ float red[8];
    const int row = blockIdx.x, t = threadIdx.x;
    float v[4]; float s = 0.f;
#pragma unroll
    for (int i = 0; i < 4; ++i) { const int c = t + 256 * i; v[i] = alpha * H[(size_t)row * D + c] + O[(size_t)row * D + c]; s += v[i]; }
    s = wave_sum(s); if ((t & 63) == 0) red[t >> 6] = s; __syncthreads();
    const float mean = (red[0] + red[1] + red[2] + red[3]) / (float)D;
    float q = 0.f;
#pragma unroll
    for (int i = 0; i < 4; ++i) { const float d = v[i] - mean; q += d * d; }
    q = wave_sum(q); if ((t & 63) == 0) red[4 + (t >> 6)] = q; __syncthreads();
    const float var = (red[4] + red[5] + red[6] + red[7]) / (float)D;
    const float r = 1.0f / sqrtf(var + LN_EPS);
#pragma unroll
    for (int i = 0; i < 4; ++i) { const int c = t + 256 * i; H[(size_t)row * D + c] = (v[i] - mean) * r * g[c] + b[c]; }
}
__global__ void conv_gate(const float* __restrict__ P, const float* __restrict__ cw, float* __restrict__ Y) {
    const int n = L * D;
    for (int i = blockIdx.x * blockDim.x + threadIdx.x; i < n; i += gridDim.x * blockDim.x) {
        const int c = i % D, t = i / D;
        const float* p = P + (size_t)t * CONV_IN;
        float conv = p[1024 + c] * p[2048 + c] * cw[2 * D + c];
        if (t >= 1) conv += (p - CONV_IN)[1024 + c] * (p - CONV_IN)[2048 + c] * cw[1 * D + c];
        if (t >= 2) conv += (p - 2 * CONV_IN)[1024 + c] * (p - 2 * CONV_IN)[2048 + c] * cw[0 * D + c];
        const float z = p[3072 + c];
        Y[i] = p[c] * conv * (z / (1.0f + __expf(-z)));
    }
}
__global__ void write_out(const float* __restrict__ H, float* __restrict__ out) {
    const size_t n = (size_t)BATCH * SEQ * D;
    for (size_t i = (size_t)blockIdx.x * blockDim.x + threadIdx.x; i < n; i += (size_t)gridDim.x * blockDim.x) {
        const int d = (int)(i % D); const size_t r = i / D; const int t = (int)(r % SEQ); const int b = (int)(r / SEQ);
        out[i] = H[((size_t)b * L + NMETA + t) * D + d];
    }
}
static void gemm(const float* A, int lda, const float* W, int ldw, float* C, int ldc, int M, int N, int K, hipStream_t s) {
    dim3 grid((N + 63) / 64, (M + 63) / 64);
    hipLaunchKernelGGL(gemm_f32, grid, dim3(256), 0, s, A, lda, W, ldw, C, ldc, M, N, K);
}
}

extern "C" void kernel_launch(void* const* d_in, const int* in_sizes, int n_in, void* d_out, int out_size, void* d_ws, size_t ws_size, hipStream_t stream) {
    using namespace v0;
    const float* x = (const float*)d_in[0]; const int* positions = (const int*)d_in[1]; const float* meta = (const float*)d_in[2];
    const float* ln_g = (const float*)d_in[3]; const float* ln_b = (const float*)d_in[4];
    const float* mla_w_in = (const float*)d_in[5]; const float* mla_qg = (const float*)d_in[6]; const float* mla_w_uq = (const float*)d_in[7];
    const float* mla_kvg = (const float*)d_in[8]; const float* mla_w_uk = (const float*)d_in[9]; const float* mla_w_uv = (const float*)d_in[10];
    const float* mla_w_o = (const float*)d_in[11]; const float* conv_w_in = (const float*)d_in[12]; const float* conv_w = (const float*)d_in[13];
    const float* conv_w_out = (const float*)d_in[14];
    float* ws = (float*)d_ws;
    float* H = ws;                                   ws += (size_t)BATCH * L * D;
    float* CS = ws;                                  ws += (size_t)BATCH * L * 16;
    float* SN = ws;                                  ws += (size_t)BATCH * L * 16;
    float* P = ws;                                   ws += (size_t)L * CONV_IN;
    float* Qb = ws;                                  ws += (size_t)L * QW;
    float* KNb = ws;                                 ws += (size_t)L * D;
    float* Vb = ws;                                  ws += (size_t)L * D;
    float* Gb = ws;                                  ws += (size_t)L * D;
    const float alpha = powf(8.0f, 0.25f);
    hipLaunchKernelGGL(build_h, dim3(2048), dim3(256), 0, stream, x, meta, H);
    hipLaunchKernelGGL(rope_table, dim3(512), dim3(256), 0, stream, positions, CS, SN);
    for (int layer = 0; layer < 4; ++layer) {
        const int j = layer / 2;
        for (int b = 0; b < BATCH; ++b) {
            float* Hb = H + (size_t)b * L * D; const float* cs = CS + (size_t)b * L * 16; const float* sn = SN + (size_t)b * L * 16;
            if (layer % 2 == 0) {
                gemm(Hb, D, mla_w_in + (size_t)j * D * MLA_IN, MLA_IN, P, CONV_IN, L, MLA_IN, D, stream);
                hipLaunchKernelGGL(rmsnorm_inplace, dim3((L + 3) / 4), dim3(256), 0, stream, P, CONV_IN, 0, QL, mla_qg + j * QL, L);
                hipLaunchKernelGGL(rmsnorm_inplace, dim3((L + 3) / 4), dim3(256), 0, stream, P, CONV_IN, QL, KVL, mla_kvg + j * KVL, L);
                hipLaunchKernelGGL(rope_inplace, dim3(256), dim3(256), 0, stream, P, CONV_IN, QL + KVL, 1, 0, cs, sn, L);
                gemm(P, CONV_IN, mla_w_uq + (size_t)j * QL * QW, QW, Qb, QW, L, QW, QL, stream);
                hipLaunchKernelGGL(rope_inplace, dim3(1024), dim3(256), 0, stream, Qb, QW, QKN, HEADS, QKN + QKR, cs, sn, L);
                gemm(P + QL, CONV_IN, mla_w_uk + (size_t)j * KVL * D, D, KNb, D, L, D, KVL, stream);
                gemm(P + QL, CONV_IN, mla_w_uv + (size_t)j * KVL * D, D, Vb, D, L, D, KVL, stream);
                hipLaunchKernelGGL(attn_naive, dim3(65, HEADS), dim3(64), 0, stream, Qb, KNb, P, Vb, Gb);
                gemm(Gb, D, mla_w_o + (size_t)j * D * D, D, KNb, D, L, D, D, stream);
                hipLaunchKernelGGL(ln_residual, dim3(L), dim3(256), 0, stream, Hb, KNb, ln_g + layer * D, ln_b + layer * D, alpha);
            } else {
                gemm(Hb, D, conv_w_in + (size_t)j * D * CONV_IN, CONV_IN, P, CONV_IN, L, CONV_IN, D, stream);
                hipLaunchKernelGGL(conv_gate, dim3(2048), dim3(256), 0, stream, P, conv_w + (size_t)j * 3 * D, Gb);
                gemm(Gb, D, conv_w_out + (size_t)j * D * D, D, KNb, D, L, D, D, stream);
                hipLaunchKernelGGL(ln_residual, dim3(L), dim3(256), 0, stream, Hb, KNb, ln_g + layer * D, ln_b + layer * D, alpha);
            }
        }
    }
    hipLaunchKernelGGL(write_out, dim3(2048), dim3(256), 0, stream, H, (float*)d_out);
}
```
